# Optimizing an MI355X kernel written in HIP

```python
import math
import jax
import jax.numpy as jnp
from jax import lax
import numpy as np

D_MODEL = 1024
BATCH = 8
SEQ = 4096
DEPTH = 2

BRANCH_W = D_MODEL // 2
N_BRANCH = 3
SSM_GROUP = 16
SSM_GROUPS = BRANCH_W // SSM_GROUP
SSM_STATE = 64
M_HEADS = 4
M_HEAD_DIM = BRANCH_W // M_HEADS
M_CHUNK = 64
CONV_WIDTH = 4
A_HEADS = 4
A_V_DIM = BRANCH_W // A_HEADS
A_QK_DIM = A_V_DIM // 2
Q_BLOCK = 128
REL_BUCKETS = 32
REL_MAX_DIST = 128
EPS = 1e-6
NEG_INF = -1e30

IN_SPLITS = (
    BRANCH_W, BRANCH_W,
    BRANCH_W, BRANCH_W, BRANCH_W, BRANCH_W, BRANCH_W,
    M_HEADS, M_HEADS,
    BRANCH_W, BRANCH_W, BRANCH_W, BRANCH_W,
    N_BRANCH * D_MODEL,
)
D_IN = sum(IN_SPLITS)

kernel_name = "hybrid_s5_mlstm_diffattn_gated_block"


def rms_norm(x, g):
    xf = x.astype(jnp.float32)
    y = xf * lax.rsqrt(jnp.mean(xf * xf, axis=-1, keepdims=True) + EPS)
    return (y * g.astype(jnp.float32)).astype(x.dtype)


def head_rms_norm(h, g, n_heads):
    shp = h.shape
    hf = h.astype(jnp.float32).reshape(shp[:-1] + (n_heads, -1))
    hf = hf * lax.rsqrt(jnp.mean(hf * hf, axis=-1, keepdims=True) + EPS)
    return (hf.reshape(shp) * g.astype(jnp.float32)).astype(h.dtype)


def split_cols(y):
    outs, start = [], 0
    for size in IN_SPLITS:
        outs.append(y[..., start:start + size])
        start += size
    return outs


def causal_conv(x, w, b):
    L = x.shape[1]
    xp = jnp.pad(x, ((0, 0), (CONV_WIDTH - 1, 0), (0, 0)))
    y = b
    for j in range(CONV_WIDTH):
        y = y + xp[:, j:j + L] * w[j]
    return y


def s5_mixer(u, lam_re, lam_im, b_re, b_im, c_re, c_im, d_skip, log_step, w_glu, b_glu):
    f32 = jnp.float32
    Bsz, L, W = u.shape
    uf = u.astype(f32).reshape(Bsz, L, SSM_GROUPS, SSM_GROUP)
    step = jnp.exp(log_step.astype(f32))[:, None]
    lre, lim = lam_re.astype(f32), lam_im.astype(f32)
    mag = jnp.exp(lre * step)
    abar_re, abar_im = mag * jnp.cos(lim * step), mag * jnp.sin(lim * step)
    den = lre * lre + lim * lim
    nre, nim = abar_re - 1.0, abar_im
    r_re = ((nre * lre + nim * lim) / den)[..., None]
    r_im = ((nim * lre - nre * lim) / den)[..., None]
    bre, bim = b_re.astype(f32), b_im.astype(f32)
    bbar_re = r_re * bre - r_im * bim
    bbar_im = r_re * bim + r_im * bre
    bu_re = jnp.einsum('blgc,gpc->blgp', uf, bbar_re)
    bu_im = jnp.einsum('blgc,gpc->blgp', uf, bbar_im)
    a_re = jnp.broadcast_to(abar_re, (1, L, SSM_GROUPS, SSM_STATE))
    a_im = jnp.broadcast_to(abar_im, (1, L, SSM_GROUPS, SSM_STATE))

    def combine(left, right):
        a1r, a1i, b1r, b1i = left
        a2r, a2i, b2r, b2i = right
        return (a2r * a1r - a2i * a1i,
                a2r * a1i + a2i * a1r,
                a2r * b1r - a2i * b1i + b2r,
                a2r * b1i + a2i * b1r + b2i)

    _, _, xr, xi = lax.associative_scan(combine, (a_re, a_im, bu_re, bu_im), axis=1)
    y = (jnp.einsum('blgp,gcp->blgc', xr, c_re.astype(f32))
         - jnp.einsum('blgp,gcp->blgc', xi, c_im.astype(f32)))
    y = y.reshape(Bsz, L, W) + d_skip.astype(f32) * uf.reshape(Bsz, L, W)
    g = jax.nn.gelu(y)
    out = g * jax.nn.sigmoid(g @ w_glu.astype(f32) + b_glu.astype(f32))
    return out.astype(u.dtype)


def mlstm_chunkwise(q, k, v, i_pre, f_pre):
    f32 = jnp.float32
    Bsz, L, H, Dh = q.shape
    T = M_CHUNK
    NC = L // T

    def to_chunks(a):
        return a.astype(f32).reshape(Bsz, NC, T, H, Dh).transpose(0, 3, 1, 2, 4)

    qc, kc, vc = to_chunks(q), to_chunks(k) * (Dh ** -0.5), to_chunks(v)
    ig = i_pre.astype(f32).reshape(Bsz, NC, T, H).transpose(0, 3, 1, 2)
    logf = jax.nn.log_sigmoid(f_pre.astype(f32)).reshape(Bsz, NC, T, H).transpose(0, 3, 1, 2)
    b = jnp.cumsum(logf, axis=-1)
    b_last = b[..., -1]

    a = b_last[..., None] - b + ig
    m_loc = jnp.max(a, axis=-1)
    w = jnp.exp(a - m_loc[..., None])
    C_loc = jnp.einsum('bhnt,bhntv,bhntk->bhnvk', w, vc, kc)
    n_loc = jnp.einsum('bhnt,bhntk->bhnk', w, kc)

    def step(carry, inp):
        C, n, m = carry
        bl, ml, Cl, nl = inp
        m_new = jnp.maximum(bl + m, ml)
        s_old = jnp.exp(bl + m - m_new)
        s_loc = jnp.exp(ml - m_new)
        C_new = s_old[..., None, None] * C + s_loc[..., None, None] * Cl
        n_new = s_old[..., None] * n + s_loc[..., None] * nl
        return (C_new, n_new, m_new), (C, n, m)

    init = (jnp.zeros((Bsz, H, Dh, Dh), f32), jnp.zeros((Bsz, H, Dh), f32), jnp.zeros((Bsz, H), f32))
    xs = (jnp.moveaxis(b_last, -1, 0), jnp.moveaxis(m_loc, -1, 0),
          jnp.moveaxis(C_loc, 2, 0), jnp.moveaxis(n_loc, 2, 0))
    _, (C_prev, n_prev, m_prev) = lax.scan(step, init, xs)
    C_prev = jnp.moveaxis(C_prev, 0, 2)
    n_prev = jnp.moveaxis(n_prev, 0, 2)
    m_prev = jnp.moveaxis(m_prev, 0, -1)

    causal = jnp.tril(jnp.ones((T, T), dtype=bool))
    d_mat = jnp.where(causal, b[..., :, None] - b[..., None, :] + ig[..., None, :], NEG_INF)
    m_intra = jnp.max(d_mat, axis=-1)
    m_inter = b + m_prev[..., None]
    m_t = jnp.maximum(m_inter, m_intra)
    s_mat = jnp.einsum('bhntd,bhnsd->bhnts', qc, kc) * jnp.exp(d_mat - m_t[..., None])
    inter = jnp.exp(m_inter - m_t)
    num = (jnp.einsum('bhnts,bhnsv->bhntv', s_mat, vc)
           + inter[..., None] * jnp.einsum('bhnvk,bhntk->bhntv', C_prev, qc))
    den = jnp.sum(s_mat, axis=-1) + inter * jnp.einsum('bhnk,bhntk->bhnt', n_prev, qc)
    h = num / jnp.maximum(jnp.abs(den), jnp.exp(-m_t))[..., None]
    return h.transpose(0, 2, 3, 1, 4).reshape(Bsz, L, H * Dh).astype(q.dtype)


def relative_bucket(rel):
    n = jnp.maximum(rel, 0)
    max_exact = REL_BUCKETS // 2
    large = max_exact + (jnp.log(jnp.maximum(n, 1).astype(jnp.float32) / max_exact)
                         / math.log(REL_MAX_DIST / max_exact)
                         * (REL_BUCKETS - max_exact)).astype(jnp.int32)
    large = jnp.minimum(large, REL_BUCKETS - 1)
    return jnp.where(n < max_exact, n, large)


def diff_attention(q, k, v, lam, rel_bias):
    f32 = jnp.float32
    Bsz, L, H, _, dqk = q.shape
    NB = L // Q_BLOCK
    qb = (q.astype(f32) * (dqk ** -0.5)).reshape(Bsz, NB, Q_BLOCK, H, 2, dqk).transpose(1, 0, 3, 4, 2, 5)
    kf = k.astype(f32).transpose(0, 2, 3, 1, 4)
    vf = v.astype(f32).transpose(0, 2, 1, 3)
    table = rel_bias.astype(f32)
    kpos = jnp.arange(L)

    def block(args):
        qblk, blk = args
        qpos = blk * Q_BLOCK + jnp.arange(Q_BLOCK)
        rel = qpos[:, None] - kpos[None, :]
        bias = table[relative_bucket(rel)].transpose(2, 0, 1)
        logits = jnp.einsum('bhcqd,bhckd->bhcqk', qblk, kf) + bias[None, :, None]
        logits = jnp.where(rel >= 0, logits, NEG_INF)
        p = jax.nn.softmax(logits, axis=-1)
        attn = p[:, :, 0] - lam * p[:, :, 1]
        return jnp.einsum('bhqk,bhkv->bhqv', attn, vf)

    out = lax.map(block, (qb, jnp.arange(NB)))
    return out.transpose(1, 0, 3, 2, 4).reshape(Bsz, L, H * v.shape[-1]).astype(v.dtype)


def hybrid_layer(x, layer_idx, norm_g, w_in, conv_w, conv_b, if_bias, m_norm_g,
                 lam_re, lam_im, b_re, b_im, c_re, c_im, d_skip, log_step, w_glu, b_glu,
                 diff_lam, a_norm_g, rel_bias, w_branch, w_out):
    Bsz, L, _ = x.shape
    h = rms_norm(x, norm_g)
    proj = h @ w_in
    (s_u, s_z, m_q, m_k, m_v, m_o, m_z, m_i, m_f,
     a_q, a_k, a_v, a_z, g_pre) = split_cols(proj)

    y_ssm = s5_mixer(s_u, lam_re, lam_im, b_re, b_im, c_re, c_im, d_skip, log_step, w_glu, b_glu)
    y_ssm = y_ssm * jax.nn.silu(s_z)

    qk = jax.nn.silu(causal_conv(jnp.concatenate([m_q, m_k], axis=-1), conv_w, conv_b))
    mq, mk = qk[..., :BRANCH_W], qk[..., BRANCH_W:]
    hm = mlstm_chunkwise(mq.reshape(Bsz, L, M_HEADS, M_HEAD_DIM),
                         mk.reshape(Bsz, L, M_HEADS, M_HEAD_DIM),
                         m_v.reshape(Bsz, L, M_HEADS, M_HEAD_DIM),
                         m_i + if_bias[0], m_f + if_bias[1])
    hm = jax.nn.sigmoid(m_o) * hm
    y_mlstm = head_rms_norm(hm, m_norm_g, M_HEADS) * jax.nn.silu(m_z)

    lam_init = 0.8 - 0.6 * math.exp(-0.3 * layer_idx)
    lf = diff_lam.astype(jnp.float32)
    lam = jnp.exp(jnp.sum(lf[0] * lf[1])) - jnp.exp(jnp.sum(lf[2] * lf[3])) + lam_init
    ha = diff_attention(a_q.reshape(Bsz, L, A_HEADS, 2, A_QK_DIM),
                        a_k.reshape(Bsz, L, A_HEADS, 2, A_QK_DIM),
                        a_v.reshape(Bsz, L, A_HEADS, A_V_DIM), lam, rel_bias)
    y_attn = head_rms_norm(ha, a_norm_g, A_HEADS) * (1.0 - lam_init) * jax.nn.silu(a_z)

    gates = jax.nn.sigmoid(g_pre).reshape(Bsz, L, N_BRANCH, D_MODEL)
    merged = (gates[:, :, 0] * (y_ssm @ w_branch[0])
              + gates[:, :, 1] * (y_mlstm @ w_branch[1])
              + gates[:, :, 2] * (y_attn @ w_branch[2]))
    return x + merged @ w_out


def setup_inputs(seed: int = 0) -> dict:
    key = jax.random.key(seed)
    ks = jax.random.split(key, 24)
    f32 = jnp.float32

    def nrm(k, shape, scale):
        return jax.random.normal(k, shape, f32) * scale

    G, P, W = SSM_GROUPS, SSM_STATE, BRANCH_W
    x = nrm(ks[0], (BATCH, SEQ, D_MODEL), 1.0)
    norm_g = 1.0 + nrm(ks[1], (DEPTH, D_MODEL), 0.02)
    w_in = nrm(ks[2], (DEPTH, D_MODEL, D_IN), D_MODEL ** -0.5)
    conv_w = nrm(ks[3], (DEPTH, CONV_WIDTH, 2 * W), CONV_WIDTH ** -0.5)
    conv_b = nrm(ks[4], (DEPTH, 2 * W), 0.02)
    f_bias = jnp.linspace(3.0, 6.0, M_HEADS, dtype=f32)
    if_bias = jnp.stack([nrm(ks[5], (DEPTH, M_HEADS), 0.1),
                         f_bias + nrm(ks[6], (DEPTH, M_HEADS), 0.1)], axis=1)
    m_norm_g = 1.0 + nrm(ks[7], (DEPTH, W), 0.02)
    ssm_lam_re = -0.5 + nrm(ks[8], (DEPTH, G, P), 0.01)
    ssm_lam_im = math.pi * jnp.arange(P, dtype=f32) + nrm(ks[9], (DEPTH, G, P), 0.01)
    ssm_b_re = nrm(ks[10], (DEPTH, G, P, SSM_GROUP), (2 * SSM_GROUP) ** -0.5)
    ssm_b_im = nrm(ks[11], (DEPTH, G, P, SSM_GROUP), (2 * SSM_GROUP) ** -0.5)
    ssm_c_re = nrm(ks[12], (DEPTH, G, SSM_GROUP, P), (2 * P) ** -0.5)
    ssm_c_im = nrm(ks[13], (DEPTH, G, SSM_GROUP, P), (2 * P) ** -0.5)
    ssm_d = nrm(ks[14], (DEPTH, W), 0.5)
    ssm_log_step = jax.random.uniform(ks[15], (DEPTH, G), f32, math.log(1e-3), math.log(1e-1))
    ssm_w_glu = nrm(ks[16], (DEPTH, W, W), W ** -0.5)
    ssm_b_glu = nrm(ks[17], (DEPTH, W), 0.02)
    diff_lam = nrm(ks[18], (DEPTH, 4, A_QK_DIM), 0.1)
    diff_norm_g = 1.0 + nrm(ks[19], (DEPTH, W), 0.02)
    rel_bias = nrm(ks[20], (REL_BUCKETS, A_HEADS), 0.2)
    w_branch = nrm(ks[21], (DEPTH, N_BRANCH, W, D_MODEL), W ** -0.5)
    w_out = nrm(ks[22], (DEPTH, D_MODEL, D_MODEL), D_MODEL ** -0.5)
    final_g = 1.0 + nrm(ks[23], (D_MODEL,), 0.02)
    return {"x": x, "norm_g": norm_g, "w_in": w_in, "conv_w": conv_w, "conv_b": conv_b,
            "if_bias": if_bias, "m_norm_g": m_norm_g, "ssm_lam_re": ssm_lam_re,
            "ssm_lam_im": ssm_lam_im, "ssm_b_re": ssm_b_re, "ssm_b_im": ssm_b_im,
            "ssm_c_re": ssm_c_re, "ssm_c_im": ssm_c_im, "ssm_d": ssm_d,
            "ssm_log_step": ssm_log_step, "ssm_w_glu": ssm_w_glu, "ssm_b_glu": ssm_b_glu,
            "diff_lam": diff_lam, "diff_norm_g": diff_norm_g, "rel_bias": rel_bias,
            "w_branch": w_branch, "w_out": w_out, "final_g": final_g}


def reference(x, norm_g, w_in, conv_w, conv_b, if_bias, m_norm_g, ssm_lam_re, ssm_lam_im,
              ssm_b_re, ssm_b_im, ssm_c_re, ssm_c_im, ssm_d, ssm_log_step, ssm_w_glu,
              ssm_b_glu, diff_lam, diff_norm_g, rel_bias, w_branch, w_out, final_g):
    for l in range(DEPTH):
        x = hybrid_layer(x, l, norm_g[l], w_in[l], conv_w[l], conv_b[l], if_bias[l], m_norm_g[l],
                         ssm_lam_re[l], ssm_lam_im[l], ssm_b_re[l], ssm_b_im[l],
                         ssm_c_re[l], ssm_c_im[l], ssm_d[l], ssm_log_step[l],
                         ssm_w_glu[l], ssm_b_glu[l], diff_lam[l], diff_norm_g[l],
                         rel_bias, w_branch[l], w_out[l])
    return rms_norm(x, final_g)
```

```cpp
#define MK_FUSED 0
#include <hip/hip_runtime.h>
#include <cstdio>
#include <cstdint>

#ifndef MK_PHMASK
#define MK_PHMASK 0x7ff
#endif
#define MK_EN(i) ((MK_PHMASK >> (i)) & 1)
#define LAS __attribute__((address_space(3)))
#define GAS __attribute__((address_space(1)))
typedef unsigned short bf16_t;
typedef short bf16x8 __attribute__((ext_vector_type(8)));
typedef short s16x4 __attribute__((ext_vector_type(4)));
typedef float f32x2 __attribute__((ext_vector_type(2)));
typedef float f32x4 __attribute__((ext_vector_type(4)));
typedef float f32x16 __attribute__((ext_vector_type(16)));
typedef unsigned u32x2 __attribute__((ext_vector_type(2)));
typedef unsigned u32x4 __attribute__((ext_vector_type(4)));
typedef __bf16 bf16x2_t __attribute__((ext_vector_type(2)));
typedef const float* const __attribute__((address_space(4))) * InPtr;

constexpr int NB = 8, SEQ = 4096, DM = 1024, MT = NB * SEQ, BW = 512, NLAYER = 2, DIN = 8712;
constexpr int N1 = 5632;
constexpr int NG = 3072;
constexpr int COL_IF = 3584;
constexpr int COL_G = 5640;
constexpr float EPS = 1e-6f;
constexpr float LOG2E = 1.4426950408889634f;

constexpr size_t MiB = 1u << 20;
constexpr size_t WS_CTL = 0, CTL_BYTES = 65536;
constexpr size_t WS_RS = 1 * MiB;
constexpr size_t WS_GIF = 2 * MiB;
constexpr size_t WS_WIF = 3 * MiB;
constexpr size_t WS_W1 = 4 * MiB;
constexpr size_t WS_WG = 26 * MiB;
constexpr size_t WS_WGLU = 38 * MiB;
constexpr size_t WS_WBR = 39 * MiB;
constexpr size_t WS_WOUT = 45 * MiB;
constexpr size_t WS_XB = 50 * MiB;
constexpr size_t WS_PROJ = 114 * MiB;
constexpr size_t SLOT_BYTES = (size_t)MT * BW * 2;
constexpr size_t WS_END = WS_PROJ + 11 * SLOT_BYTES;
constexpr int SL_SU = 0, SL_MO = 1, SL_SZ = 2, SL_MZ = 3, SL_AZ = 4, SL_MQ = 5, SL_MK = 6, SL_MV = 7, SL_AQ = 8, SL_AK = 9, SL_AV = 10;
constexpr int CW_BAR = 4096;
constexpr int CW_QUEUE = 1024;

constexpr int NWAVES = 8, NTHREADS = 512;
constexpr int LDS_MAIN = 135168 + 1024;
constexpr int LDSCTL_OFF = LDS_MAIN, LDS_BYTES = LDS_MAIN + 512;

__device__ __forceinline__ float bf2f(unsigned short h) { return __uint_as_float(((unsigned)h) << 16); }
__device__ __forceinline__ unsigned pk2(float lo, float hi) { f32x2 v = {lo, hi}; bf16x2_t b = __builtin_convertvector(v, bf16x2_t); return __builtin_bit_cast(unsigned, b); }
__device__ __forceinline__ float sigmoidf_(float x) { return __builtin_amdgcn_rcpf(1.0f + __builtin_amdgcn_exp2f(-x * LOG2E)); }
__device__ __forceinline__ float siluf_(float x) { return x * sigmoidf_(x); }
__device__ __forceinline__ float geluf_(float x) {
    const float u = 1.5957691216057308f * (x + 0.044715f * x * x * x);
    return x * sigmoidf_(u);
}
__device__ __forceinline__ float wave_sum(float v) {
#pragma unroll
    for (int o = 1; o < 64; o <<= 1) v += __shfl_xor(v, o);
    return v;
}
#define LDS_WAIT() asm volatile("s_waitcnt lgkmcnt(0)" ::: "memory")
#define VM_WAIT() asm volatile("s_waitcnt vmcnt(0)" ::: "memory")
#define MEMFENCE() asm volatile("" ::: "memory")
#define MFMA32(a, b, c) __builtin_amdgcn_mfma_f32_32x32x16_bf16((a), (b), (c), 0, 0, 0)
#define MFMA16(a, b, c) __builtin_amdgcn_mfma_f32_16x16x32_bf16((a), (b), (c), 0, 0, 0)
__device__ __forceinline__ int crow(int r, int hi) { return (r & 3) + 8 * (r >> 2) + 4 * hi; }
typedef short v4i16_t __attribute__((ext_vector_type(4)));
__device__ __forceinline__ s16x4 tr_read(const LAS unsigned char* p) { return __builtin_bit_cast(s16x4, __builtin_amdgcn_ds_read_tr16_b64_v4i16((LAS v4i16_t*)p)); }
__device__ __forceinline__ bf16x8 cat8(s16x4 lo, s16x4 hi) { return __builtin_shufflevector(lo, hi, 0, 1, 2, 3, 4, 5, 6, 7); }

#define XB_TMO      128
#define XB_XCNT(j)  (256  + 64 * (j))
#define XB_XSUB(j)  (1280 + 64 * (j))
#define XB_XGEN(j)  (2304 + 64 * (j))
#define XB_TOP      3328
#define XB_TOPGEN   3392
#define XCD_BAR_WORDS 3456
#define XB_SPIN_CAP (1u << 18)

__device__ __forceinline__ unsigned xb_ld(unsigned* p)              { return __hip_atomic_load(p, __ATOMIC_RELAXED, __HIP_MEMORY_SCOPE_AGENT); }
__device__ __forceinline__ unsigned xb_add(unsigned* p, unsigned v) { return __hip_atomic_fetch_add(p, v, __ATOMIC_RELAXED, __HIP_MEMORY_SCOPE_AGENT); }
__device__ __forceinline__ unsigned xb_xcc_id() { return (unsigned)__builtin_amdgcn_s_getreg((3 << 11) | 20) & 0xFu; }
#define XB_SPIN(cond, bar) do { unsigned _sp = 0; while (cond) { __builtin_amdgcn_s_sleep(1); \
    if ((++_sp & 255u) == 0u) { if (xb_ld(&(bar)[XB_TMO])) break; if (_sp > XB_SPIN_CAP) { atomicAdd(&(bar)[XB_TMO], 1u); break; } } } } while (0)

struct XcdBarrier {
    unsigned* bar; unsigned x;
    volatile LAS unsigned* st;
};

__device__ __forceinline__ XcdBarrier xcd_barrier_post(unsigned* bar, volatile LAS unsigned* st) {
    XcdBarrier b; b.bar = bar; b.x = xb_xcc_id(); b.st = st;
    if (threadIdx.x == 0) (void)xb_add(&bar[XB_XCNT(b.x)], 1u);
    return b;
}
__device__ __forceinline__ void xcd_barrier_complete(unsigned* bar, unsigned x, unsigned& nloc, unsigned& nx) {
    const unsigned G = gridDim.x * gridDim.y * gridDim.z;
    unsigned sum, cnt, mine, sp = 0u;
    for (;;) {
        sum = 0u; cnt = 0u; mine = 0u;
#pragma unroll
        for (unsigned j = 0; j < 16; ++j) { const unsigned c = xb_ld(&bar[XB_XCNT(j)]); sum += c; cnt += (c > 0u) ? 1u : 0u; mine = (j == x) ? c : mine; }
        if (sum == G) break;
        __builtin_amdgcn_s_sleep(1);
        if ((++sp & 255u) == 0u) { if (xb_ld(&bar[XB_TMO])) break; if (sp > XB_SPIN_CAP) { atomicAdd(&bar[XB_TMO], 1u); break; } }
    }
    nloc = mine > 0u ? mine : 1u; nx = cnt > 0u ? cnt : 1u;
}

__device__ __forceinline__ void xcd_barrier(const XcdBarrier& b) {
    asm volatile("s_waitcnt vmcnt(0)" ::: "memory");
    __syncthreads();
    if (threadIdx.x == 0) {
        unsigned* bar = b.bar;
        __builtin_amdgcn_s_waitcnt(0);
        unsigned nloc = b.st[0], nx = b.st[1];
        if (nloc == 0u) { xcd_barrier_complete(bar, b.x, nloc, nx); b.st[0] = nloc; b.st[1] = nx; }
        const unsigned old = xb_add(&bar[XB_XSUB(b.x)], 1u);
        const unsigned gen = old / nloc;
        if (old + 1u == (gen + 1u) * nloc) {
            __builtin_amdgcn_fence(__ATOMIC_RELEASE, "agent");
            asm volatile("s_waitcnt vmcnt(0)" ::: "memory");
            const unsigned og = xb_add(&bar[XB_TOP], 1u);
            const unsigned tg = og / nx;
            if (og + 1u == (tg + 1u) * nx) xb_add(&bar[XB_TOPGEN], 1u);
            else XB_SPIN(xb_ld(&bar[XB_TOPGEN]) == tg, bar);
            __builtin_amdgcn_fence(__ATOMIC_ACQUIRE, "agent");
            xb_add(&bar[XB_XGEN(b.x)], 1u);
            asm volatile("s_waitcnt vmcnt(0)" ::: "memory");
        } else {
            XB_SPIN(xb_ld(&bar[XB_XGEN(b.x)]) == gen, bar);
            __builtin_amdgcn_fence(__ATOMIC_ACQUIRE, "agent");
            asm volatile("s_waitcnt vmcnt(0)" ::: "memory");
        }
    }
    __syncthreads();
}
namespace pg8 {
#define PG8_LAS __attribute__((address_space(3)))
typedef unsigned short bf16_t;
typedef short bf16x8 __attribute__((ext_vector_type(8)));
typedef float f32x4 __attribute__((ext_vector_type(4)));
typedef unsigned u32x4 __attribute__((ext_vector_type(4)));
constexpr int BM = 256, BK = 64, HALF = 128, HTB = HALF * BK * 2  , STAGE_BYTES = 8 * HTB, NXCD = 8, WGM = 8;

__host__ __device__ __forceinline__ int lds_byte(int r, int c) { const int st = (r >> 4) * 2 + (c >> 5), rr = r & 15, cc = c & 31, ob = rr * 64 + cc * 2; return st * 1024 + (ob ^ (((ob >> 9) & 1) << 5)); }
__host__ __device__ __forceinline__ void stage_rc(int b, int& R, int& C) { const int st = b / 1024, sb = b % 1024, swz = sb ^ (((sb >> 9) & 1) << 5); R = (st >> 1) * 16 + swz / 64; C = (st & 1) * 32 + (swz % 64) / 2; }
__host__ __device__ __forceinline__ int perm32(int rho) { const int n = rho >> 4, i = rho & 15; return 8 * (i >> 2) + 4 * n + (i & 3); }

struct Unit { int pm, pn, z; };
struct Gemm { const bf16_t* A; const bf16_t* Bt; int M, N, K; size_t zA, zB;   };

struct StaticOrder {
    int nM, nN, nwg, G, c;
    __host__ __device__ void init(int M, int N, int G_, int c_) { nM = M / BM; nN = N / BM; nwg = nM * nN; G = G_; c = c_; }
    __host__ __device__ bool next(int i, Unit& u) const {
        const long L = (long)i * G + c; if (L >= nwg) return false;
        int wgid = (int)L; { const int q = nwg / NXCD, r = nwg % NXCD, xcd = wgid % NXCD, off = wgid / NXCD; wgid = (xcd < r ? xcd * (q + 1) : r * (q + 1) + (xcd - r) * q) + off; }
        const int nig = WGM * nN, gid = wgid / nig, fm = gid * WGM, gsz = (nM - fm) < WGM ? (nM - fm) : WGM;
        u.pm = fm + ((wgid % nig) % gsz); u.pn = (wgid % nig) / gsz; u.z = 0; return true;
    }
    __device__ __forceinline__ void a_ready(const Unit&) const {}
    __device__ __forceinline__ void done(const Unit&) const {}
};

typedef float f32x2 __attribute__((ext_vector_type(2)));
template <class Epi, class Sched, bool ALIGN_EPI = false, bool SP2 = false>
__device__ __forceinline__ void gemm_phase(PG8_LAS unsigned char* lds, const Gemm g, const Sched& S, const Epi& E, int tid_in) {
    int tid = tid_in; asm volatile("" : "+v"(tid));
    const int wid = __builtin_amdgcn_readfirstlane(tid >> 6), lane = tid & 63, wr = wid >> 2, wc = wid & 3, fr = lane & 15, fq = lane >> 4;
    const int K = g.K, nt = K / BK;
    unsigned voffA[2], voffB[2];
#pragma unroll
    for (int i = 0; i < 2; ++i) { int R, C; stage_rc(tid * 16 + i * 8192, R, C); const int Rb = Epi::PERM ? ((R & ~31) + perm32(R & 31)) : R;
        voffA[i] = (unsigned)(R * K + C) * 2u; voffB[i] = (unsigned)(Rb * K + C) * 2u; }
    const size_t kstep = (size_t)(BK * 2);
    const size_t hstep = (size_t)HALF * K * 2;
    const size_t tstep = 2 * hstep;
    const unsigned ldsw = (unsigned)wid * 1024u;
    const int aoff = lds_byte(wr * 64 + fr, fq * 8), boff = lds_byte(wc * 32 + fr, fq * 8);
#define PG8_SA(b, h) (((b) * 2 + (h)) * HTB)
#define PG8_SB(b, h) ((4 + (b) * 2 + (h)) * HTB)
#define PG8_STAGE(bufoff, gbase, voff) do { _Pragma("unroll") for (int _i = 0; _i < 2; ++_i) \
        __builtin_amdgcn_global_load_lds((const unsigned*)((const char*)(gbase) + (voff)[_i]), (PG8_LAS unsigned*)(lds + (bufoff) + ldsw + _i * 8192), 16, 0, 0); } while (0)
#define PG8_LDA(dst, b, h) do { _Pragma("unroll") for (int m = 0; m < 4; ++m) _Pragma("unroll") for (int k = 0; k < 2; ++k) dst[m][k] = *(const PG8_LAS bf16x8*)(lds + PG8_SA(b, h) + aoff + m * 2048 + k * 1024); } while (0)
#define PG8_LDB(dst, b, h) do { _Pragma("unroll") for (int n = 0; n < 2; ++n) _Pragma("unroll") for (int k = 0; k < 2; ++k) dst[n][k] = *(const PG8_LAS bf16x8*)(lds + PG8_SB(b, h) + boff + n * 2048 + k * 1024); } while (0)
#define PG8_MMA(ai, bj, At, Bt) do { __builtin_amdgcn_s_setprio(1); _Pragma("unroll") for (int m = 0; m < 4; ++m) _Pragma("unroll") for (int n = 0; n < 2; ++n) _Pragma("unroll") for (int k = 0; k < 2; ++k) \
        acc[ai][bj][m][n] = __builtin_amdgcn_mfma_f32_16x16x32_bf16(Bt[n][k], At[m][k], acc[ai][bj][m][n], 0, 0, 0); __builtin_amdgcn_s_setprio(0); } while (0)
#define PG8_WAIT_V(n) asm volatile("s_waitcnt vmcnt(" #n ")" ::: "memory")
#define PG8_WAIT_L(n) asm volatile("s_waitcnt lgkmcnt(" #n ")" ::: "memory")
#define PG8_BAR __builtin_amdgcn_s_barrier()
#define PG8_SCHED __builtin_amdgcn_sched_barrier(0)
    Unit cur, nxt; int ui = 0;
    if (!S.next(0, cur)) return;
    f32x4 acc[2][2][4][2];
#pragma unroll
    for (int a = 0; a < 2; ++a)
#pragma unroll
        for (int b = 0; b < 2; ++b)
#pragma unroll
            for (int m = 0; m < 4; ++m)
#pragma unroll
                for (int n = 0; n < 2; ++n) acc[a][b][m][n] = (f32x4){0.f, 0.f, 0.f, 0.f};
    bf16x8 At[4][2], B0[2][2], B1[2][2];
    const char* cA = (const char*)g.A + (size_t)cur.pm * tstep + (size_t)cur.z * g.zA; const char* cB = (const char*)g.Bt + (size_t)cur.pn * tstep + (size_t)cur.z * g.zB;
    S.a_ready(cur);
    if constexpr (SP2) {
        PG8_STAGE(PG8_SB(0, 0), cB, voffB); PG8_STAGE(PG8_SB(0, 1), cB + hstep, voffB); PG8_STAGE(PG8_SA(0, 0), cA, voffA); PG8_STAGE(PG8_SA(0, 1), cA + hstep, voffA);
        if (wr == 1) PG8_BAR;
        PG8_WAIT_V(2); PG8_BAR;
        PG8_STAGE(PG8_SB(1, 0), cB + kstep, voffB); PG8_STAGE(PG8_SA(1, 0), cA + kstep, voffA); PG8_STAGE(PG8_SB(1, 1), cB + hstep + kstep, voffB);
        PG8_WAIT_V(6); PG8_BAR;
    } else {
        PG8_STAGE(PG8_SB(0, 0), cB, voffB); PG8_STAGE(PG8_SA(0, 0), cA, voffA); PG8_STAGE(PG8_SB(0, 1), cB + hstep, voffB); PG8_STAGE(PG8_SA(0, 1), cA + hstep, voffA);
        if (wr == 1) PG8_BAR;
        PG8_WAIT_V(4); PG8_BAR;
        PG8_STAGE(PG8_SB(1, 0), cB + kstep, voffB); PG8_STAGE(PG8_SA(1, 0), cA + kstep, voffA); PG8_STAGE(PG8_SB(1, 1), cB + hstep + kstep, voffB);
        PG8_WAIT_V(6); PG8_BAR;
    }
    for (;;) {
        const bool has_next = S.next(ui + 1, nxt);
        const char* nA = has_next ? (const char*)g.A + (size_t)nxt.pm * tstep + (size_t)nxt.z * g.zA : cA; const char* nB = has_next ? (const char*)g.Bt + (size_t)nxt.pn * tstep + (size_t)nxt.z * g.zB : cB;
        for (int t = 0; t < nt; t += 2) {
            const bool last = (t == nt - 2);
            const char* a1 = cA + (size_t)(t + 1) * kstep;
            const char* a2 = last ? nA : cA + (size_t)(t + 2) * kstep; const char* b2 = last ? nB : cB + (size_t)(t + 2) * kstep;
            const char* a3 = a2 + kstep; const char* b3 = b2 + kstep;
            if (last && has_next) S.a_ready(nxt);
            if constexpr (SP2) {
            PG8_LDB(B0, 0, 0); PG8_LDB(B1, 0, 1); PG8_SCHED; PG8_LDA(At, 0, 0); PG8_STAGE(PG8_SA(1, 1), a1 + hstep, voffA);
            PG8_WAIT_V(8); PG8_WAIT_L(0); PG8_BAR; PG8_MMA(0, 0, At, B0); PG8_MMA(0, 1, At, B1); PG8_BAR; PG8_SCHED;
            PG8_LDA(At, 0, 1); PG8_STAGE(PG8_SB(0, 0), b2, voffB); PG8_STAGE(PG8_SB(0, 1), b2 + hstep, voffB); PG8_STAGE(PG8_SA(0, 0), a2, voffA);
            PG8_WAIT_V(8); PG8_WAIT_L(0); PG8_BAR; PG8_MMA(1, 0, At, B0); PG8_MMA(1, 1, At, B1); PG8_BAR; PG8_SCHED;
            PG8_LDB(B0, 1, 0); PG8_LDB(B1, 1, 1); PG8_SCHED; PG8_LDA(At, 1, 0); PG8_STAGE(PG8_SA(0, 1), a2 + hstep, voffA);
            PG8_WAIT_V(8); PG8_WAIT_L(0); PG8_BAR; PG8_MMA(0, 0, At, B0); PG8_MMA(0, 1, At, B1); PG8_BAR; PG8_SCHED;
            PG8_LDA(At, 1, 1); PG8_STAGE(PG8_SB(1, 0), b3, voffB); PG8_STAGE(PG8_SB(1, 1), b3 + hstep, voffB); PG8_STAGE(PG8_SA(1, 0), a3, voffA);
            PG8_WAIT_V(8); PG8_WAIT_L(0); PG8_BAR; PG8_MMA(1, 0, At, B0); PG8_MMA(1, 1, At, B1); PG8_BAR; PG8_SCHED;
            } else {
            PG8_LDB(B0, 0, 0); PG8_SCHED; PG8_LDA(At, 0, 0); PG8_STAGE(PG8_SA(1, 1), a1 + hstep, voffA);
            PG8_WAIT_L(8); PG8_BAR; PG8_WAIT_L(0); PG8_MMA(0, 0, At, B0); PG8_BAR; PG8_SCHED;
            PG8_LDB(B1, 0, 1); PG8_STAGE(PG8_SB(0, 0), b2, voffB);
            PG8_BAR; PG8_WAIT_L(0); PG8_MMA(0, 1, At, B1); PG8_BAR;
            PG8_LDA(At, 0, 1); PG8_STAGE(PG8_SA(0, 0), a2, voffA);
            PG8_BAR; PG8_WAIT_L(0); PG8_MMA(1, 0, At, B0); PG8_BAR; PG8_SCHED;
            PG8_STAGE(PG8_SB(0, 1), b2 + hstep, voffB);
            PG8_WAIT_V(6); PG8_BAR; PG8_MMA(1, 1, At, B1); PG8_BAR;
            PG8_LDB(B0, 1, 0); PG8_SCHED; PG8_LDA(At, 1, 0); PG8_STAGE(PG8_SA(0, 1), a2 + hstep, voffA);
            PG8_WAIT_L(8); PG8_BAR; PG8_WAIT_L(0); PG8_MMA(0, 0, At, B0); PG8_BAR; PG8_SCHED;
            PG8_LDB(B1, 1, 1); PG8_STAGE(PG8_SB(1, 0), b3, voffB);
            PG8_BAR; PG8_WAIT_L(0); PG8_MMA(0, 1, At, B1); PG8_BAR;
            PG8_LDA(At, 1, 1); PG8_STAGE(PG8_SA(1, 0), a3, voffA);
            PG8_BAR; PG8_WAIT_L(0); PG8_MMA(1, 0, At, B0); PG8_BAR; PG8_SCHED;
            PG8_STAGE(PG8_SB(1, 1), b3 + hstep, voffB);
            PG8_WAIT_V(6); PG8_BAR; PG8_MMA(1, 1, At, B1); PG8_BAR;
            }
        }
        if constexpr (ALIGN_EPI) { if (wr == 0) PG8_BAR; }
        if constexpr (!Epi::AFTER_DRAIN) { E(acc, cur, wr, wc, fr, fq); S.done(cur); }
        if (!has_next) break;
if (!E.keep(cur)) {
#pragma unroll
        for (int a = 0; a < 2; ++a)
#pragma unroll
            for (int b = 0; b < 2; ++b)
#pragma unroll
                for (int m = 0; m < 4; ++m)
#pragma unroll
                    for (int n = 0; n < 2; ++n) acc[a][b][m][n] = (f32x4){0.f, 0.f, 0.f, 0.f};
        }
        cur = nxt; cA = nA; cB = nB; ++ui;
        if constexpr (ALIGN_EPI) { if (wr == 1) PG8_BAR; }
    }
    PG8_WAIT_V(0);
    if constexpr (!ALIGN_EPI) { if (wr == 0) PG8_BAR; }
    PG8_BAR;
    if constexpr (Epi::AFTER_DRAIN) { E.fused(acc, cur, wr, wc, fr, fq, lds, wid, lane); S.done(cur); }
#undef PG8_SA
#undef PG8_SB
#undef PG8_STAGE
#undef PG8_LDA
#undef PG8_LDB
#undef PG8_MMA
#undef PG8_WAIT_V
#undef PG8_WAIT_L
#undef PG8_BAR
#undef PG8_SCHED
}
}
namespace pg8 {
typedef f32x4 Acc[2][2][4][2];

struct EpiProj {
    static constexpr bool PERM = true, AFTER_DRAIN = false;
    bf16_t* proj; const float* rs; float az_scale;
    __device__ __forceinline__ bool keep(const Unit&) const { return false; }
    __device__ __forceinline__ void operator()(Acc& acc, const Unit& u, int wr, int wc, int fr, int fq) const {
        const int t = u.pn >> 1;
        const int slot = (t == 0) ? SL_SU : (t == 1) ? SL_SZ : (t == 2) ? SL_MQ : (t == 3) ? SL_MK : (t == 4) ? SL_MV : (t == 5) ? SL_MO : (t == 6) ? SL_MZ : (t == 7) ? SL_AQ : (t == 8) ? SL_AK : (t == 9) ? SL_AV : SL_AZ;
        const bool useS = (t == 1) || (t == 5) || (t == 6) || (t == 10);
        const bool useV = (t != 5);
        const float cst = (t == 7) ? (0.125f * LOG2E) : (t == 10) ? az_scale : 1.0f;
        bf16_t* base = proj + (size_t)slot * ((size_t)MT * BW);
        const int row0 = u.pm * BM + wr * 64 + fr, col0 = (u.pn & 1) * 256 + wc * 32 + 8 * fq;
#pragma unroll
        for (int ai = 0; ai < 2; ++ai)
#pragma unroll
            for (int m = 0; m < 4; ++m) {
                const int row = row0 + ai * HALF + m * 16;
                const float rstd = __builtin_amdgcn_rsqf(rs[row] * (1.0f / DM) + EPS);
                bf16_t* rowp = base + (size_t)row * BW + col0;
#pragma unroll
                for (int bj = 0; bj < 2; ++bj) {
                    float o[8];
#pragma unroll
                    for (int n = 0; n < 2; ++n)
#pragma unroll
                        for (int e = 0; e < 4; ++e) {
                            const float v = acc[ai][bj][m][n][e] * rstd;
                            const float s = useS ? sigmoidf_(v) : 1.0f;
                            o[n * 4 + e] = (useV ? v : 1.0f) * s * cst;
                        }
                    u32x4 w; w.x = pk2(o[0], o[1]); w.y = pk2(o[2], o[3]); w.z = pk2(o[4], o[5]); w.w = pk2(o[6], o[7]);
                    *(u32x4*)(rowp + bj * HALF) = w;
                }
                __builtin_amdgcn_sched_barrier(0);
            }
    }
};

struct EpiGate {
    static constexpr bool PERM = true, AFTER_DRAIN = false;
    bf16_t* gates; const float* rs;
    __device__ __forceinline__ bool keep(const Unit&) const { return false; }
    __device__ __forceinline__ void operator()(Acc& acc, const Unit& u, int wr, int wc, int fr, int fq) const {
        const int br = u.pn >> 2;
        bf16_t* base = gates + (size_t)br * ((size_t)MT * DM);
        const int row0 = u.pm * BM + wr * 64 + fr, col0 = (u.pn & 3) * 256 + wc * 32 + 8 * fq;
#pragma unroll
        for (int ai = 0; ai < 2; ++ai)
#pragma unroll
            for (int m = 0; m < 4; ++m) {
                const int row = row0 + ai * HALF + m * 16;
                const float rstd = __builtin_amdgcn_rsqf(rs[row] * (1.0f / DM) + EPS);
                bf16_t* rowp = base + (size_t)row * DM + col0;
#pragma unroll
                for (int bj = 0; bj < 2; ++bj) {
                    float o[8];
#pragma unroll
                    for (int n = 0; n < 2; ++n)
#pragma unroll
                        for (int e = 0; e < 4; ++e) o[n * 4 + e] = sigmoidf_(acc[ai][bj][m][n][e] * rstd);
                    u32x4 w; w.x = pk2(o[0], o[1]); w.y = pk2(o[2], o[3]); w.z = pk2(o[4], o[5]); w.w = pk2(o[6], o[7]);
                    *(u32x4*)(rowp + bj * HALF) = w;
                }
                __builtin_amdgcn_sched_barrier(0);
            }
    }
};

struct EpiGlu {
    static constexpr bool PERM = true, AFTER_DRAIN = false;
    const bf16_t* g; bf16_t* szy; const float* bias;
    __device__ __forceinline__ bool keep(const Unit&) const { return false; }
    __device__ __forceinline__ void operator()(Acc& acc, const Unit& u, int wr, int wc, int fr, int fq) const {
        const int row0 = u.pm * BM + wr * 64 + fr, col0 = u.pn * BM + wc * 32 + 8 * fq;
#pragma unroll
        for (int ai = 0; ai < 2; ++ai)
#pragma unroll
            for (int m = 0; m < 4; ++m) {
                const size_t off = (size_t)(row0 + ai * HALF + m * 16) * BW + col0;
#pragma unroll
                for (int bj = 0; bj < 2; ++bj) {
                    const u32x4 gv = *(const u32x4*)(g + off + bj * HALF);
                    const u32x4 zv = *(const u32x4*)(szy + off + bj * HALF);
                    const f32x4 bv0 = *(const f32x4*)(bias + col0 + bj * HALF), bv1 = *(const f32x4*)(bias + col0 + bj * HALF + 4);
                    float o[8];
#pragma unroll
                    for (int n = 0; n < 2; ++n)
#pragma unroll
                        for (int e = 0; e < 4; ++e) {
                            const int i = n * 4 + e; const unsigned gw = gv[i >> 1], zw = zv[i >> 1];
                            const float gg = (i & 1) ? __uint_as_float(gw & 0xffff0000u) : __uint_as_float(gw << 16);
                            const float zz = (i & 1) ? __uint_as_float(zw & 0xffff0000u) : __uint_as_float(zw << 16);
                            o[i] = gg * sigmoidf_(acc[ai][bj][m][n][e] + (n ? bv1[e] : bv0[e])) * zz;
                        }
                    u32x4 w; w.x = pk2(o[0], o[1]); w.y = pk2(o[2], o[3]); w.z = pk2(o[4], o[5]); w.w = pk2(o[6], o[7]);
                    *(u32x4*)(szy + off + bj * HALF) = w;
                }
                __builtin_amdgcn_sched_barrier(0);
            }
    }
};

struct EpiMerge {
    static constexpr bool PERM = true, AFTER_DRAIN = false;
    const bf16_t* gates; bf16_t* merged;
    __device__ __forceinline__ bool keep(const Unit& u) const { return u.z != 2; }
    __device__ __forceinline__ void operator()(Acc& acc, const Unit& u, int wr, int wc, int fr, int fq) const {
        const int row0 = u.pm * BM + wr * 64 + fr, col0 = u.pn * BM + wc * 32 + 8 * fq;
        const bf16_t* ga = gates + (size_t)u.z * ((size_t)MT * DM);
        const bf16_t* gb = gates + (size_t)(u.z < 2 ? u.z + 1 : 2) * ((size_t)MT * DM);
        const bool last = (u.z == 2);
#pragma unroll
        for (int ai = 0; ai < 2; ++ai)
#pragma unroll
            for (int m = 0; m < 4; ++m) {
                const size_t off = (size_t)(row0 + ai * HALF + m * 16) * DM + col0;
#pragma unroll
                for (int bj = 0; bj < 2; ++bj) {
                    const u32x4 av = *(const u32x4*)(ga + off + bj * HALF);
                    const u32x4 bv = *(const u32x4*)(gb + off + bj * HALF);
                    float o[8];
#pragma unroll
                    for (int n = 0; n < 2; ++n)
#pragma unroll
                        for (int e = 0; e < 4; ++e) {
                            const int i = n * 4 + e; const unsigned aw = av[i >> 1], bw = bv[i >> 1];
                            const float a = (i & 1) ? __uint_as_float(aw & 0xffff0000u) : __uint_as_float(aw << 16);
                            const float b = (i & 1) ? __uint_as_float(bw & 0xffff0000u) : __uint_as_float(bw << 16);
                            const float f = last ? a : a * __builtin_amdgcn_rcpf(b);
                            const float v = acc[ai][bj][m][n][e] * f;
                            acc[ai][bj][m][n][e] = v; o[i] = v;
                        }
                    if (last) {
                        u32x4 w; w.x = pk2(o[0], o[1]); w.y = pk2(o[2], o[3]); w.z = pk2(o[4], o[5]); w.w = pk2(o[6], o[7]);
                        *(u32x4*)(merged + off + bj * HALF) = w;
                    }
                }
                __builtin_amdgcn_sched_barrier(0);
            }
    }
};

struct EpiOut {
    static constexpr bool PERM = false, AFTER_DRAIN = false;
    const float* resid; float* xout; bf16_t* xb; float* rs_next;
    __device__ __forceinline__ bool keep(const Unit&) const { return false; }
    __device__ __forceinline__ void operator()(Acc& acc, const Unit& u, int wr, int wc, int fr, int fq) const {
        const int row0 = u.pm * BM + wr * 64 + fr, col0 = u.pn * BM + wc * 32 + 4 * fq;
#pragma unroll
        for (int ai = 0; ai < 2; ++ai)
#pragma unroll
            for (int m = 0; m < 4; ++m) {
                const int row = row0 + ai * HALF + m * 16;
                const size_t off = (size_t)row * DM + col0;
                float ss = 0.f;
#pragma unroll
                for (int bj = 0; bj < 2; ++bj)
#pragma unroll
                    for (int n = 0; n < 2; ++n) {
                        const f32x4 r = *(const f32x4*)(resid + off + bj * HALF + n * 16);
                        const f32x4 v = r + acc[ai][bj][m][n];
                        *(f32x4*)(xout + off + bj * HALF + n * 16) = v;
                        u32x2 w; w.x = pk2(v[0], v[1]); w.y = pk2(v[2], v[3]);
                        *(u32x2*)(xb + off + bj * HALF + n * 16) = w;
                        ss += (v[0] * v[0] + v[1] * v[1]) + (v[2] * v[2] + v[3] * v[3]);
                    }
                ss += __shfl_xor(ss, 16); ss += __shfl_xor(ss, 32);
                if (fq == 0) atomicAdd(rs_next + row, ss);
                __builtin_amdgcn_sched_barrier(0);
            }
    }
};

struct MergeOrder {
    StaticOrder S;
    __device__ __forceinline__ bool next(int i, Unit& u) const { if (!S.next(i / 3, u)) return false; u.z = i % 3; return true; }
    __device__ __forceinline__ void a_ready(const Unit&) const {}
    __device__ __forceinline__ void done(const Unit&) const {}
};
}
__device__ __forceinline__ void ssm_wave_unit(InPtr in, int layer, int b, int g, bf16_t* su, LAS unsigned char* X, int lane) {
    const float* lam_re = in[7]; const float* lam_im = in[8]; const float* b_re = in[9]; const float* b_im = in[10];
    const float* c_re = in[11]; const float* c_im = in[12]; const float* d_skip = in[13]; const float* log_step = in[14];
    const int r32 = lane & 31, hi = lane >> 5, lg = layer * 32 + g;
    const float step = expf(log_step[lg]);
    float ar, ai;
    { const float lre = lam_re[lg * 64 + lane], lim = lam_im[lg * 64 + lane]; const float mag = expf(lre * step); ar = mag * cosf(lim * step); ai = mag * sinf(lim * step); }
    bf16x8 bfrag[4];
#pragma unroll
    for (int ph = 0; ph < 2; ++ph) {
        const int p = 32 * ph + r32;
        const float lre = lam_re[lg * 64 + p], lim = lam_im[lg * 64 + p];
        const float mag = expf(lre * step), are = mag * cosf(lim * step), aim = mag * sinf(lim * step);
        const float den = lre * lre + lim * lim, nre = are - 1.0f, nim = aim;
        const float rre = (nre * lre + nim * lim) / den, rim = (nim * lre - nre * lim) / den;
        float vr[8], vi[8];
#pragma unroll
        for (int j = 0; j < 8; ++j) {
            const float br = b_re[((size_t)lg * 64 + p) * 16 + 8 * hi + j], bi = b_im[((size_t)lg * 64 + p) * 16 + 8 * hi + j];
            vr[j] = rre * br - rim * bi; vi[j] = rre * bi + rim * br;
        }
        u32x4 wr_, wi_;
        wr_.x = pk2(vr[0], vr[1]); wr_.y = pk2(vr[2], vr[3]); wr_.z = pk2(vr[4], vr[5]); wr_.w = pk2(vr[6], vr[7]);
        wi_.x = pk2(vi[0], vi[1]); wi_.y = pk2(vi[2], vi[3]); wi_.z = pk2(vi[4], vi[5]); wi_.w = pk2(vi[6], vi[7]);
        bfrag[ph] = __builtin_bit_cast(bf16x8, wr_); bfrag[2 + ph] = __builtin_bit_cast(bf16x8, wi_);
    }
    bf16x8 cfrag[8], dfrag;
#pragma unroll
    for (int s = 0; s < 8; ++s) {
        float v[8];
#pragma unroll
        for (int j = 0; j < 8; ++j) {
            const int pp = 16 * s + 8 * hi + j;
            float x = 0.f;
            if (r32 < 16) x = (pp < 64) ? c_re[((size_t)lg * 16 + r32) * 64 + pp] : -c_im[((size_t)lg * 16 + r32) * 64 + (pp - 64)];
            v[j] = x;
        }
        u32x4 w; w.x = pk2(v[0], v[1]); w.y = pk2(v[2], v[3]); w.z = pk2(v[4], v[5]); w.w = pk2(v[6], v[7]);
        cfrag[s] = __builtin_bit_cast(bf16x8, w);
    }
    {
        float v[8];
#pragma unroll
        for (int j = 0; j < 8; ++j) v[j] = (r32 < 16 && r32 == 8 * hi + j) ? d_skip[layer * BW + g * 16 + r32] : 0.f;
        u32x4 w; w.x = pk2(v[0], v[1]); w.y = pk2(v[2], v[3]); w.z = pk2(v[4], v[5]); w.w = pk2(v[6], v[7]);
        dfrag = __builtin_bit_cast(bf16x8, w);
    }
    float xr = 0.f, xi = 0.f;
    bf16_t* ubase = su + ((size_t)b * SEQ + r32) * BW + g * 16;
    bf16x8 ufrag = *(const bf16x8*)(ubase + 8 * hi);
    LAS float* Xf = (LAS float*)X;
    for (int ch = 0; ch < SEQ / 32; ++ch) {
        bf16_t* urow = ubase + (size_t)ch * 32 * BW;
        const bf16x8 ucur = ufrag;
        if (ch + 1 < SEQ / 32) ufrag = *(const bf16x8*)(urow + (size_t)32 * BW + 8 * hi);
        const f32x16 zero = {0.f, 0.f, 0.f, 0.f, 0.f, 0.f, 0.f, 0.f, 0.f, 0.f, 0.f, 0.f, 0.f, 0.f, 0.f, 0.f};
#pragma unroll
        for (int mt = 0; mt < 4; ++mt) {
            const f32x16 d = MFMA32(bfrag[mt], ucur, zero);
#pragma unroll
            for (int q = 0; q < 4; ++q) {
                f32x4 v = {d[4 * q], d[4 * q + 1], d[4 * q + 2], d[4 * q + 3]};
                *(LAS f32x4*)(Xf + r32 * 132 + 32 * mt + 8 * q + 4 * hi) = v;
            }
        }
        MEMFENCE();
        float br[32], bi[32];
#pragma unroll
        for (int t = 0; t < 32; ++t) { br[t] = Xf[t * 132 + lane]; bi[t] = Xf[t * 132 + 64 + lane]; }
        MEMFENCE();
#pragma unroll
        for (int t = 0; t < 32; ++t) {
            const float nr = ar * xr - ai * xi + br[t], ni = ar * xi + ai * xr + bi[t];
            xr = nr; xi = ni;
            const unsigned w = pk2(nr, ni);
            *(LAS unsigned short*)(X + t * 528 + 2 * lane) = (unsigned short)(w & 0xffffu);
            *(LAS unsigned short*)(X + t * 528 + 128 + 2 * lane) = (unsigned short)(w >> 16);
        }
        MEMFENCE();
        f32x16 y = zero;
#pragma unroll
        for (int s = 0; s < 8; ++s) {
            const bf16x8 xf = *(const LAS bf16x8*)(X + r32 * 528 + (16 * s + 8 * hi) * 2);
            y = MFMA32(cfrag[s], xf, y);
        }
        y = MFMA32(dfrag, ucur, y);
        MEMFENCE();
        u32x2 o0, o1;
        o0.x = pk2(geluf_(y[0]), geluf_(y[1])); o0.y = pk2(geluf_(y[2]), geluf_(y[3]));
        o1.x = pk2(geluf_(y[4]), geluf_(y[5])); o1.y = pk2(geluf_(y[6]), geluf_(y[7]));
        *(u32x2*)(urow + 4 * hi) = o0;
        *(u32x2*)(urow + 8 + 4 * hi) = o1;
    }
}
constexpr int ML_QT = 0, ML_KT = 17408, ML_VT = 34816, ML_SM = 54272, ML_SC = 63488, ML_C1 = 65536, ML_END = 73728;
constexpr int ML_PQ = 272, ML_PV = 304, ML_PS = 144;
enum { SC_U = 0, SC_M = 64, SC_INTER = 128, SC_EMT = 192, SC_WP = 256, SC_DEN = 320, SC_SS = 384, SC_MISC = 448 };

template <bool DEN>
__device__ __forceinline__ void ml_tile(f32x4 (&C)[8], f32x4 (&num)[4], int vc, float s_old, LAS unsigned char* lds, LAS float* SC, int i16, int q4) {
    f32x4 acc2[4];
#pragma unroll
    for (int mt = 0; mt < 4; ++mt) acc2[mt] = (f32x4){0.f, 0.f, 0.f, 0.f};
#pragma unroll
    for (int kk = 0; kk < 4; ++kk) {
        u32x4 w; w.x = pk2(C[2 * kk][0], C[2 * kk][1]); w.y = pk2(C[2 * kk][2], C[2 * kk][3]);
        w.z = pk2(C[2 * kk + 1][0], C[2 * kk + 1][1]); w.w = pk2(C[2 * kk + 1][2], C[2 * kk + 1][3]);
        const bf16x8 bc = __builtin_bit_cast(bf16x8, w);
#pragma unroll
        for (int mt = 0; mt < 4; ++mt) {
            const s16x4 lo = *(const LAS s16x4*)(lds + ML_QT + (16 * mt + i16) * ML_PQ + (32 * kk + 4 * q4) * 2);
            const s16x4 hi_ = *(const LAS s16x4*)(lds + ML_QT + (16 * mt + i16) * ML_PQ + (32 * kk + 16 + 4 * q4) * 2);
            acc2[mt] = MFMA16(cat8(lo, hi_), bc, acc2[mt]);
        }
    }
    bf16x8 bv[2];
#pragma unroll
    for (int kk = 0; kk < 2; ++kk) {
        const LAS unsigned char* p = lds + ML_VT + (32 * kk + 8 * q4 + (i16 >> 2)) * ML_PV + (vc + 4 * (i16 & 3)) * 2;
        bv[kk] = cat8(tr_read(p), tr_read(p + 4 * ML_PV));
    }
#pragma unroll
    for (int mt = 0; mt < 4; ++mt) {
        f32x4 acc1 = {0.f, 0.f, 0.f, 0.f};
#pragma unroll
        for (int kk = 0; kk < 2; ++kk) {
            const bf16x8 sa = *(const LAS bf16x8*)(lds + ML_SM + (16 * mt + i16) * ML_PS + (32 * kk + 8 * q4) * 2);
            acc1 = MFMA16(sa, bv[kk], acc1);
        }
#pragma unroll
        for (int r = 0; r < 4; ++r) {
            const int t = 16 * mt + 4 * q4 + r;
            const float v = acc1[r] + SC[SC_INTER + t] * acc2[mt][r];
            if (!DEN) num[mt][r] = v; else if (i16 == 0) SC[SC_DEN + t] = v;
        }
    }
    __builtin_amdgcn_sched_barrier(0);
#pragma unroll
    for (int i = 0; i < 8; ++i) C[i] = C[i] * s_old;
#pragma unroll
    for (int tt = 0; tt < 2; ++tt) {
        const f32x4 w0 = *(const LAS f32x4*)(SC + SC_WP + 32 * tt + 8 * q4), w1 = *(const LAS f32x4*)(SC + SC_WP + 32 * tt + 8 * q4 + 4);
        float sv[8];
#pragma unroll
        for (int j = 0; j < 8; ++j) sv[j] = bf2f((unsigned short)bv[tt][j]) * (j < 4 ? w0[j] : w1[j - 4]);
        u32x4 w; w.x = pk2(sv[0], sv[1]); w.y = pk2(sv[2], sv[3]); w.z = pk2(sv[4], sv[5]); w.w = pk2(sv[6], sv[7]);
        const bf16x8 bw = __builtin_bit_cast(bf16x8, w);
#pragma unroll
        for (int i = 0; i < 8; ++i) {
            const LAS unsigned char* p = lds + ML_KT + (32 * tt + 8 * q4 + (i16 >> 2)) * ML_PQ + (16 * i + 4 * (i16 & 3)) * 2;
            const bf16x8 ka = cat8(tr_read(p), tr_read(p + 4 * ML_PQ));
            C[i] = MFMA16(ka, bw, C[i]);
        }
    }
}

__device__ __forceinline__ void mlstm_unit(InPtr in, int layer, int b, int h, const bf16_t* mq, const bf16_t* mk, const bf16_t* mv, const bf16_t* mo, bf16_t* mzy,
                                           const float* gif, LAS unsigned char* lds, int tid) {
    const float* conv_w = in[3] + (size_t)layer * 4 * 1024; const float* conv_b = in[4] + (size_t)layer * 1024;
    const float* if_bias = in[5] + layer * 8; const float* gam = in[6] + layer * BW + h * 128;
    const int wave = __builtin_amdgcn_readfirstlane(tid >> 6);
    LAS float* SC = (LAS float*)(lds + ML_SC);
    const bf16_t* vsrc = mv + (size_t)b * SEQ * BW + h * 128;
    const bf16_t* mqb = mq + (size_t)b * SEQ * BW + h * 128; const bf16_t* mkb = mk + (size_t)b * SEQ * BW + h * 128;
    if (tid < 64) { unsigned one_ = 0x00003F80u, zero_ = 0u; asm volatile("" : "+v"(one_), "+v"(zero_));
        LAS unsigned* p = (LAS unsigned*)(lds + ML_VT + tid * ML_PV + 256); p[0] = one_; p[1] = zero_; p[2] = zero_; p[3] = zero_; p[4] = zero_; p[5] = zero_; p[6] = zero_; p[7] = zero_; }
    f32x4 Ct[8];
#pragma unroll
    for (int i = 0; i < 8; ++i) Ct[i] = (f32x4){0.f, 0.f, 0.f, 0.f};
    if (tid < 64) {
#pragma unroll
        for (int i = 0; i < 8; ++i) *(LAS f32x4*)(lds + ML_C1 + (i * 64 + tid) * 16) = (f32x4){0.f, 0.f, 0.f, 0.f};
    }
    float m_prev = 0.f;
    const float bias_i = if_bias[h], bias_f = if_bias[4 + h];
    u32x4 raw[7], vraw[2]; float gi = 0.f, gf = 0.f;
#define ML_PREFETCH(n_, tid__) do { const int n__ = (n_); const int cm__ = (tid__) >> 8, crs__ = ((tid__) >> 4) & 15, ccg__ = (tid__) & 15; const int t0__ = n__ * 64 + 4 * crs__ - 3; \
        const bf16_t* csrc = (cm__ ? mkb : mqb) + ccg__ * 8; \
        _Pragma("unroll") for (int r = 0; r < 7; ++r) { const int t = t0__ + r; raw[r] = (t >= 0) ? *(const u32x4*)(csrc + (size_t)t * BW) : (u32x4){0u, 0u, 0u, 0u}; } \
        _Pragma("unroll") for (int i = 0; i < 2; ++i) { const int idx = (tid__) + 512 * i; vraw[i] = *(const u32x4*)(vsrc + (size_t)(n__ * 64 + (idx >> 4)) * BW + (idx & 15) * 8); } \
        if (wave == 0) { const size_t row = (size_t)b * SEQ + n__ * 64 + ((tid__) & 63); gi = gif[row * 8 + h]; gf = gif[row * 8 + 4 + h]; } } while (0)
    ML_PREFETCH(0, tid);
    for (int n = 0; n < SEQ / 64; ++n) {
        int tid_ = tid; asm volatile("" : "+v"(tid_));
        const int lane = tid_ & 63, i16 = lane & 15, q4 = lane >> 4;
        const int cmat = tid_ >> 8, crs = (tid_ >> 4) & 15, ccg = tid_ & 15;
        const float* cwp = conv_w + cmat * 512 + h * 128 + ccg * 8; const float* cbp = conv_b + cmat * 512 + h * 128 + ccg * 8;
        const float kscale = cmat ? 0.08838834764831845f : 1.0f;
        {
            LAS unsigned char* dst = lds + (cmat ? ML_KT : ML_QT) + (4 * crs) * ML_PQ + ccg * 16;
            float cw[4][8], cb[8];
            { const f32x4 b0 = *(const f32x4*)cbp, b1 = *(const f32x4*)(cbp + 4);
#pragma unroll
              for (int e = 0; e < 4; ++e) { cb[e] = b0[e]; cb[4 + e] = b1[e]; }
#pragma unroll
              for (int j = 0; j < 4; ++j) { const f32x4 w0 = *(const f32x4*)(cwp + j * 1024), w1 = *(const f32x4*)(cwp + j * 1024 + 4);
#pragma unroll
                for (int e = 0; e < 4; ++e) { cw[j][e] = w0[e]; cw[j][4 + e] = w1[e]; } } }
#pragma unroll
            for (int i = 0; i < 4; ++i) {
                float o[8];
#pragma unroll
                for (int e = 0; e < 8; ++e) {
                    float y = cb[e];
#pragma unroll
                    for (int j = 0; j < 4; ++j) { const unsigned w = raw[i + j][e >> 1]; const float x = (e & 1) ? __uint_as_float(w & 0xffff0000u) : __uint_as_float(w << 16); y += cw[j][e] * x; }
                    o[e] = siluf_(y) * kscale;
                }
                u32x4 w; w.x = pk2(o[0], o[1]); w.y = pk2(o[2], o[3]); w.z = pk2(o[4], o[5]); w.w = pk2(o[6], o[7]);
                *(LAS u32x4*)(dst + i * ML_PQ) = w;
            }
#pragma unroll
            for (int i = 0; i < 2; ++i) { const int idx = tid_ + 512 * i; *(LAS u32x4*)(lds + ML_VT + (idx >> 4) * ML_PV + (idx & 15) * 16) = vraw[i]; }
        }
        float s_old_w0 = 0.f;
        if (wave == 0) {
            const float f = gf + bias_f, ig = gi + bias_i;
            const float logf_ = fminf(f, 0.f) - log1pf(expf(-fabsf(f)));
            float bsum = logf_;
#pragma unroll
            for (int o = 1; o < 64; o <<= 1) { const float t = __shfl_up(bsum, o); if (lane >= o) bsum += t; }
            const float u = ig - bsum;
            float cm = u;
#pragma unroll
            for (int o = 1; o < 64; o <<= 1) { const float t = __shfl_up(cm, o); if (lane >= o) cm = fmaxf(cm, t); }
            const float M = fmaxf(m_prev, cm);
            const float M63 = __shfl(M, 63), b63 = __shfl(bsum, 63);
            SC[SC_U + lane] = u; SC[SC_M + lane] = M; SC[SC_INTER + lane] = expf(m_prev - M); SC[SC_EMT + lane] = expf(-(bsum + M));
            SC[SC_WP + lane] = expf(u - M63); SC[SC_SS + lane] = 0.f;
            s_old_w0 = expf(m_prev - M63);
            if (lane == 0) SC[SC_MISC] = s_old_w0;
            m_prev = b63 + M63;
        }
        __syncthreads();
        { asm volatile("" : "+v"(tid_)); }
#pragma unroll
        for (int x = 0; x < 2; ++x) {
            const int tau = 2 * wave + x, mt = tau >> 2, st = tau & 3, t0 = 16 * mt, s0 = 16 * st;
            f32x4 acc = {0.f, 0.f, 0.f, 0.f};
            if (st <= mt) {
#pragma unroll
                for (int dk = 0; dk < 4; ++dk) {
                    const bf16x8 a = *(const LAS bf16x8*)(lds + ML_KT + (s0 + i16) * ML_PQ + (32 * dk + 8 * q4) * 2);
                    const bf16x8 bq = *(const LAS bf16x8*)(lds + ML_QT + (t0 + i16) * ML_PQ + (32 * dk + 8 * q4) * 2);
                    acc = MFMA16(a, bq, acc);
                }
            }
            const int t = t0 + i16; const float Mt = SC[SC_M + t];
            float o[4];
#pragma unroll
            for (int r = 0; r < 4; ++r) { const int s = s0 + 4 * q4 + r; o[r] = (s <= t) ? acc[r] * expf(SC[SC_U + s] - Mt) : 0.f; }
            u32x2 w; w.x = pk2(o[0], o[1]); w.y = pk2(o[2], o[3]);
            *(LAS u32x2*)(lds + ML_SM + t * ML_PS + (s0 + 4 * q4) * 2) = w;
        }
        __syncthreads();
        asm volatile("" : "+v"(tid_));
        const float s_old = SC[SC_MISC];
        f32x4 num[4];
        { const int l2 = tid_ & 63, i16b = l2 & 15, q4b = l2 >> 4;
          ml_tile<false>(Ct, num, 16 * wave, s_old, lds, SC, i16b, q4b);
          if (wave == 0) {
              f32x4 C1[8], dummy[4];
#pragma unroll
              for (int i = 0; i < 8; ++i) C1[i] = *(const LAS f32x4*)(lds + ML_C1 + (i * 64 + l2) * 16);
              ml_tile<true>(C1, dummy, 128, s_old, lds, SC, i16b, q4b);
#pragma unroll
              for (int i = 0; i < 8; ++i) *(LAS f32x4*)(lds + ML_C1 + (i * 64 + l2) * 16) = C1[i];
          } }
        __syncthreads();
        asm volatile("" : "+v"(tid_));
        if (n + 1 < SEQ / 64) ML_PREFETCH(n + 1, tid_);
        const bf16_t* mob = mo + ((size_t)b * SEQ + n * 64) * BW + h * 128 + 16 * wave;
        bf16_t* mzb = mzy + ((size_t)b * SEQ + n * 64) * BW + h * 128 + 16 * wave;
        const int loff = (4 * ((tid_ & 63) >> 4)) * BW + (tid_ & 15);
        float hm[4][4];
#pragma unroll
        for (int mt = 0; mt < 4; ++mt) {
            float ssq[4];
#pragma unroll
            for (int r = 0; r < 4; ++r) {
                const int t = 16 * mt + 4 * q4 + r;
                const float hval = num[mt][r] / fmaxf(fabsf(SC[SC_DEN + t]), SC[SC_EMT + t]);
                const float og = bf2f(mob[loff + (16 * mt + r) * BW]);
                hm[mt][r] = og * hval; ssq[r] = hm[mt][r] * hm[mt][r];
            }
#pragma unroll
            for (int r = 0; r < 4; ++r) {
                float v = ssq[r];
                v += __shfl_xor(v, 1); v += __shfl_xor(v, 2); v += __shfl_xor(v, 4); v += __shfl_xor(v, 8);
                if (i16 == 0) __hip_atomic_fetch_add(SC + SC_SS + 16 * mt + 4 * q4 + r, v, __ATOMIC_RELAXED, __HIP_MEMORY_SCOPE_WORKGROUP);
            }
        }
        __syncthreads();
        const float gm = gam[16 * wave + i16];
#pragma unroll
        for (int mt = 0; mt < 4; ++mt)
#pragma unroll
            for (int r = 0; r < 4; ++r) {
                const int t = 16 * mt + 4 * q4 + r;
                const float rstd = __builtin_amdgcn_rsqf(SC[SC_SS + t] * (1.0f / 128.0f) + EPS);
                bf16_t* p = mzb + loff + (16 * mt + r) * BW;
                const float y = hm[mt][r] * rstd * gm * bf2f(*p);
                *p = (bf16_t)(pk2(y, 0.f) & 0xffffu);
            }
        __syncthreads();
    }
}
constexpr int AT_BUFB = 32768, AT_K1 = 8192, AT_V = 16384, AT_BIAS = 65536, AT_SCR = 66048, AT_END = 68096;
constexpr float AT_NEG = -1e30f, AT_THR = 8.0f;

__device__ __forceinline__ float swap_max(float x) { auto rr = __builtin_amdgcn_permlane32_swap(__float_as_uint(x), __float_as_uint(x), false, false); return fmaxf(__uint_as_float(rr[0]), __uint_as_float(rr[1])); }
__device__ __forceinline__ float swap_sum(float x) { auto rr = __builtin_amdgcn_permlane32_swap(__float_as_uint(x), __float_as_uint(x), false, false); return __uint_as_float(rr[0]) + __uint_as_float(rr[1]); }

__device__ __forceinline__ void attn_unit(InPtr in, int layer, int b, int h, int qb, const bf16_t* aq, const bf16_t* ak, const bf16_t* av, bf16_t* azy, float lam,
                                          LAS unsigned char* lds, int tid) {
    const float* rel = in[19]; const float* gA = in[18] + layer * BW + h * 128;
    const int lane = tid & 63, wave = __builtin_amdgcn_readfirstlane(tid >> 6), r32 = lane & 31, hi = lane >> 5, comp = wave >> 2, wq = wave & 3;
    const int q0 = 128 * qb + 32 * wq;
    const size_t rowb = (size_t)b * SEQ;
    LAS float* BT = (LAS float*)(lds + AT_BIAS);
    LAS float* scr = (LAS float*)(lds + AT_SCR) + wave * 64;
    if (tid < 128) {
        const int n = tid; int bk = n;
        if (n >= 16) { bk = 16 + (int)(logf((float)n * (1.0f / 16.0f)) / 2.0794415416798357f * 16.0f); bk = bk > 31 ? 31 : bk; }
        BT[n] = (rel[bk * 4 + h] - rel[31 * 4 + h]) * LOG2E;
    }
    bf16x8 qf[4];
    {
        const bf16_t* qp = aq + (rowb + q0 + r32) * BW + h * 128 + comp * 64 + 8 * hi;
#pragma unroll
        for (int s = 0; s < 4; ++s) qf[s] = *(const bf16x8*)(qp + 16 * s);
    }
    const int kkey = tid >> 3, kch = tid & 7;
    const bf16_t* ksrc = ak + (rowb + kkey) * BW + h * 128 + kch * 8;
    const int kdst = kkey * 128 + ((kch ^ (kkey & 7)) << 4);
    const bf16_t* vsrc0 = av + (rowb + (tid >> 4)) * BW + h * 128 + (tid & 15) * 8;
    const int vkey0 = tid >> 4, vkey1 = vkey0 + 32, vch = tid & 15;
    const int vdst0 = AT_V + vkey0 * 256 + ((vch ^ (((vkey0 & 3) << 2) | ((vkey0 >> 2) & 3))) << 4);
    const int vdst1 = AT_V + vkey1 * 256 + ((vch ^ (((vkey1 & 3) << 2) | ((vkey1 >> 2) & 3))) << 4);
    u32x4 kr0, kr1, vr0, vr1;
#define AT_LOAD(t_) do { const size_t o_ = (size_t)(t_) * 64 * BW; kr0 = *(const u32x4*)(ksrc + o_); kr1 = *(const u32x4*)(ksrc + o_ + 64); \
        vr0 = *(const u32x4*)(vsrc0 + o_); vr1 = *(const u32x4*)(vsrc0 + o_ + (size_t)32 * BW); } while (0)
#define AT_STORE(bb_) do { LAS unsigned char* d_ = lds + (bb_) * AT_BUFB; *(LAS u32x4*)(d_ + kdst) = kr0; *(LAS u32x4*)(d_ + AT_K1 + kdst) = kr1; \
        *(LAS u32x4*)(d_ + vdst0) = vr0; *(LAS u32x4*)(d_ + vdst1) = vr1; } while (0)
    const int NT = 2 * qb + 2;
    AT_LOAD(0);
    AT_STORE(0);
    __syncthreads();
    f32x16 O[4];
#pragma unroll
    for (int n = 0; n < 4; ++n)
#pragma unroll
        for (int r = 0; r < 16; ++r) O[n][r] = 0.f;
    float m = AT_NEG, l = 0.f;
    const int i16 = lane & 15, qp_ = i16 >> 2, pp_ = i16 & 3, g1 = (lane >> 4) & 1, clow = 2 * g1 + (pp_ >> 1);
    const int vrow = (4 * hi + qp_) * 256 + 8 * (pp_ & 1);
    const int sw0 = clow ^ (hi & 3), sw1 = clow ^ ((hi + 2) & 3);
    for (int t = 0; t < NT; ++t) {
        if (t + 1 < NT) AT_LOAD(t + 1);
        if (64 * t <= q0 + 31) {
            const LAS unsigned char* Kc = lds + (t & 1) * AT_BUFB + comp * AT_K1;
            const LAS unsigned char* Vb = lds + (t & 1) * AT_BUFB + AT_V;
            f32x16 p0, p1;
#pragma unroll
            for (int r = 0; r < 16; ++r) { p0[r] = 0.f; p1[r] = 0.f; }
#pragma unroll
            for (int s = 0; s < 4; ++s) {
                const int co = ((2 * s + hi) ^ (r32 & 7)) << 4;
                const bf16x8 a0 = *(const LAS bf16x8*)(Kc + r32 * 128 + co);
                const bf16x8 a1 = *(const LAS bf16x8*)(Kc + (32 + r32) * 128 + co);
                p0 = MFMA32(a0, qf[s], p0); p1 = MFMA32(a1, qf[s], p1);
            }
            if (64 * t + 63 + 128 > q0) {
                const int qrow = q0 + r32;
#pragma unroll
                for (int r = 0; r < 16; ++r) {
                    const int d0 = qrow - (64 * t + crow(r, hi)), d1 = d0 - 32;
                    const float b0 = BT[d0 & 127], b1 = BT[d1 & 127];
                    p0[r] = (d0 < 0) ? AT_NEG : ((d0 < 128) ? p0[r] + b0 : p0[r]);
                    p1[r] = (d1 < 0) ? AT_NEG : ((d1 < 128) ? p1[r] + b1 : p1[r]);
                }
            }
            float mx = fmaxf(p0[0], p1[0]);
#pragma unroll
            for (int r = 1; r < 16; ++r) mx = fmaxf(mx, fmaxf(p0[r], p1[r]));
            mx = swap_max(mx);
            if (__any(mx > m + AT_THR)) {
                const float mn = fmaxf(m, mx), alpha = __builtin_amdgcn_exp2f(m - mn);
                l *= alpha; m = mn;
                MEMFENCE();
                if (hi == 0) scr[r32] = alpha;
                MEMFENCE();
#pragma unroll
                for (int r = 0; r < 16; ++r) {
                    const float f = scr[crow(r, hi)];
#pragma unroll
                    for (int n = 0; n < 4; ++n) O[n][r] *= f;
                }
                MEMFENCE();
            }
            float ls = 0.f;
#pragma unroll
            for (int r = 0; r < 16; ++r) { p0[r] = __builtin_amdgcn_exp2f(p0[r] - m); p1[r] = __builtin_amdgcn_exp2f(p1[r] - m); ls += p0[r] + p1[r]; }
            l += ls;
            bf16x8 pa[4];
#pragma unroll
            for (int ks = 0; ks < 4; ++ks) {
                u32x4 w;
                if (ks < 2) { w.x = pk2(p0[8 * ks], p0[8 * ks + 1]); w.y = pk2(p0[8 * ks + 2], p0[8 * ks + 3]); w.z = pk2(p0[8 * ks + 4], p0[8 * ks + 5]); w.w = pk2(p0[8 * ks + 6], p0[8 * ks + 7]); }
                else { const int k2 = ks - 2; w.x = pk2(p1[8 * k2], p1[8 * k2 + 1]); w.y = pk2(p1[8 * k2 + 2], p1[8 * k2 + 3]); w.z = pk2(p1[8 * k2 + 4], p1[8 * k2 + 5]); w.w = pk2(p1[8 * k2 + 6], p1[8 * k2 + 7]); }
                pa[ks] = __builtin_bit_cast(bf16x8, w);
            }
#pragma unroll
            for (int n = 0; n < 4; ++n) {
                const int c0 = ((((n ^ qp_) << 2) | sw0) << 4), c1 = ((((n ^ qp_) << 2) | sw1) << 4);
#pragma unroll
                for (int ks = 0; ks < 4; ++ks) {
                    const s16x4 lo = tr_read(Vb + ks * 4096 + vrow + c0);
                    const s16x4 hh = tr_read(Vb + ks * 4096 + 2048 + vrow + c1);
                    O[n] = MFMA32(pa[ks], cat8(lo, hh), O[n]);
                }
            }
        }
        if (t + 1 < NT) AT_STORE((t + 1) & 1);
        __syncthreads();
    }
#undef AT_LOAD
#undef AT_STORE
    {
        const float lt = swap_sum(l);
        const float inv = (comp ? lam : 1.0f) / lt;
        MEMFENCE();
        if (hi == 0) scr[r32] = inv;
        MEMFENCE();
#pragma unroll
        for (int r = 0; r < 16; ++r) {
            const float f = scr[crow(r, hi)];
#pragma unroll
            for (int n = 0; n < 4; ++n) O[n][r] *= f;
        }
        MEMFENCE();
    }
    LAS float* Cb = (LAS float*)lds + wq * (32 * 128);
    if (comp == 1) {
#pragma unroll
        for (int n = 0; n < 4; ++n)
#pragma unroll
            for (int r = 0; r < 16; ++r) Cb[crow(r, hi) * 128 + 32 * n + r32] = O[n][r];
    }
    __syncthreads();
    if (comp == 0) {
        float ssq[16];
#pragma unroll
        for (int r = 0; r < 16; ++r) {
            float s = 0.f;
#pragma unroll
            for (int n = 0; n < 4; ++n) { const float v = O[n][r] - Cb[crow(r, hi) * 128 + 32 * n + r32]; O[n][r] = v; s += v * v; }
            s += __shfl_xor(s, 1); s += __shfl_xor(s, 2); s += __shfl_xor(s, 4); s += __shfl_xor(s, 8); s += __shfl_xor(s, 16);
            ssq[r] = s;
        }
#pragma unroll
        for (int n = 0; n < 4; ++n) {
            const float gm = gA[32 * n + r32];
#pragma unroll
            for (int r = 0; r < 16; ++r) {
                const float rstd = __builtin_amdgcn_rsqf(ssq[r] * (1.0f / 128.0f) + EPS);
                bf16_t* p = azy + (rowb + q0 + crow(r, hi)) * BW + h * 128 + 32 * n + r32;
                const float y = O[n][r] * rstd * gm * bf2f(*p);
                *p = (bf16_t)(pk2(y, 0.f) & 0xffffu);
            }
        }
    }
    __syncthreads();
}
__device__ __forceinline__ void transpose_item(const float* W, int ldw, int col0, int K, bf16_t* WT, int row0, int k0, const float* kscale, LAS float* scr, int lane) {
#pragma unroll 8
    for (int i = 0; i < 32; ++i) { const int kk = 2 * i + (lane >> 5); const float s = kscale ? kscale[k0 + kk] : 1.0f; scr[kk * 33 + (lane & 31)] = W[(size_t)(k0 + kk) * ldw + col0 + (lane & 31)] * s; }
    LDS_WAIT(); MEMFENCE();
    const int c = lane & 7;
#pragma unroll
    for (int j = 0; j < 4; ++j) { const int n = (lane >> 3) + 8 * j; const LAS float* s = scr + (8 * c) * 33 + n;
        u32x4 o; o.x = pk2(s[0 * 33], s[1 * 33]); o.y = pk2(s[2 * 33], s[3 * 33]); o.z = pk2(s[4 * 33], s[5 * 33]); o.w = pk2(s[6 * 33], s[7 * 33]);
        *(u32x4*)(WT + (size_t)(row0 + n) * K + k0 + 8 * c) = o; }
    LDS_WAIT(); MEMFENCE();
}

__device__ __forceinline__ void phase_prologue(InPtr in, unsigned char* ws, LAS unsigned char* lds, int tid, int vcu, int G) {
    const int lane = tid & 63, wave = tid >> 6;
    LAS float* scr = (LAS float*)(lds + wave * 16384);
    const int gw = vcu * NWAVES + wave, NGW = G * NWAVES;
    const float* w_in = in[2]; const float* norm_g = in[1]; const float* w_glu = in[15]; const float* w_br = in[20]; const float* w_out = in[21];
    constexpr int I_W1 = 16 * 176, I_WG = 16 * 96, I_GLU = 8 * 16, I_BR = 3 * 8 * 32, I_OUT = 16 * 32, I_LAYER = I_W1 + I_WG + I_GLU + I_BR + I_OUT;
    for (int it = gw; it < NLAYER * I_LAYER; it += NGW) {
        const int layer = it / I_LAYER; int r = it % I_LAYER;
        if (r < I_W1) { const int kb = r / 176, nb = r % 176, n0 = 32 * nb; const int col = (n0 < COL_IF) ? n0 : n0 + 8;
            transpose_item(w_in + (size_t)layer * DM * DIN, DIN, col, DM, (bf16_t*)(ws + WS_W1) + (size_t)layer * N1 * DM, n0, 64 * kb, norm_g + layer * DM, scr, lane); continue; }
        r -= I_W1;
        if (r < I_WG) { const int kb = r / 96, nb = r % 96, n0 = 32 * nb;
            transpose_item(w_in + (size_t)layer * DM * DIN, DIN, COL_G + n0, DM, (bf16_t*)(ws + WS_WG) + (size_t)layer * NG * DM, n0, 64 * kb, norm_g + layer * DM, scr, lane); continue; }
        r -= I_WG;
        if (r < I_GLU) { const int kb = r / 16, nb = r % 16;
            transpose_item(w_glu + (size_t)layer * BW * BW, BW, 32 * nb, BW, (bf16_t*)(ws + WS_WGLU) + (size_t)layer * BW * BW, 32 * nb, 64 * kb, nullptr, scr, lane); continue; }
        r -= I_GLU;
        if (r < I_BR) { const int z = r / 256, q = r % 256, kb = q / 32, nb = q % 32;
            transpose_item(w_br + ((size_t)layer * 3 + z) * BW * DM, DM, 32 * nb, BW, (bf16_t*)(ws + WS_WBR) + ((size_t)layer * 3 + z) * DM * BW, 32 * nb, 64 * kb, nullptr, scr, lane); continue; }
        r -= I_BR;
        { const int kb = r / 32, nb = r % 32;
            transpose_item(w_out + (size_t)layer * DM * DM, DM, 32 * nb, DM, (bf16_t*)(ws + WS_WOUT) + (size_t)layer * DM * DM, 32 * nb, 64 * kb, nullptr, scr, lane); }
    }
    for (int idx = (vcu * NWAVES + wave) * 64 + lane; idx < NLAYER * 16 * DM; idx += NGW * 64) {
        const int layer = idx >> 14, col = (idx >> 10) & 15, k = idx & 1023;
        const float v = (col < 8) ? w_in[((size_t)layer * DM + k) * DIN + COL_IF + col] * norm_g[layer * DM + k] : 0.f;
        ((bf16_t*)(ws + WS_WIF))[idx] = (bf16_t)(pk2(v, 0.f) & 0xffffu);
    }
    const float* x = in[0]; bf16_t* xb = (bf16_t*)(ws + WS_XB); float* rs = (float*)(ws + WS_RS);
    for (int m = gw; m < MT; m += NGW) {
        const f32x4* xr = (const f32x4*)(x + (size_t)m * DM) + lane;
        u32x2* o8 = (u32x2*)(xb + (size_t)m * DM) + lane;
        float s = 0.f;
#pragma unroll
        for (int j = 0; j < 4; ++j) { const f32x4 v = xr[64 * j]; s += (v[0] * v[0] + v[1] * v[1]) + (v[2] * v[2] + v[3] * v[3]); u32x2 w; w.x = pk2(v[0], v[1]); w.y = pk2(v[2], v[3]); o8[64 * j] = w; }
        s = wave_sum(s);
        if (lane == 0) { rs[m] = s; rs[MT + m] = 0.f; rs[2 * MT + m] = 0.f; }
    }
}

__device__ __forceinline__ void gate_if_pass(InPtr in, unsigned char* ws, int layer, int tid, int vcu, int G) {
    const int lane = tid & 63, wave = tid >> 6, gw = vcu * NWAVES + wave, NGW = G * NWAVES, i16 = lane & 15, q4 = lane >> 4;
    const bf16_t* xb = (const bf16_t*)(ws + WS_XB); const float* rs = (const float*)(ws + WS_RS) + (size_t)layer * MT; float* gif = (float*)(ws + WS_GIF);
    const bf16_t* wt = (const bf16_t*)(ws + WS_WIF) + (size_t)layer * 16 * DM + i16 * DM + 8 * q4;
    for (int tile = gw; tile < MT / 16; tile += NGW) {
        const bf16_t* xa = xb + ((size_t)tile * 16 + i16) * DM + 8 * q4;
        f32x4 acc = {0.f, 0.f, 0.f, 0.f};
#pragma unroll 8
        for (int ks = 0; ks < 32; ++ks) { const bf16x8 av = *(const bf16x8*)(xa + 32 * ks); const bf16x8 bv = *(const bf16x8*)(wt + 32 * ks); acc = MFMA16(av, bv, acc); }
        if (i16 < 8) {
#pragma unroll
            for (int r = 0; r < 4; ++r) { const int row = tile * 16 + 4 * q4 + r; gif[(size_t)row * 8 + i16] = acc[r] * __builtin_amdgcn_rsqf(rs[row] * (1.0f / DM) + EPS); }
        }
    }
}

__device__ __forceinline__ void phase_final(InPtr in, unsigned char* ws, float* out, int tid, int vcu, int G) {
    const int lane = tid & 63, wave = tid >> 6, gw = vcu * NWAVES + wave, NGW = G * NWAVES;
    const float* fg = in[22]; const float* rs = (const float*)(ws + WS_RS) + (size_t)2 * MT;
    f32x4 g4[4];
#pragma unroll
    for (int j = 0; j < 4; ++j) g4[j] = ((const f32x4*)fg)[lane + 64 * j];
    for (int m = gw; m < MT; m += NGW) {
        f32x4* xr = (f32x4*)(out + (size_t)m * DM) + lane;
        const float rstd = __builtin_amdgcn_rsqf(rs[m] * (1.0f / DM) + EPS);
#pragma unroll
        for (int j = 0; j < 4; ++j) { const f32x4 v = xr[64 * j]; xr[64 * j] = v * rstd * g4[j]; }
    }
}

__device__ __forceinline__ void phase_mixers(InPtr in, unsigned char* ws, int layer, LAS unsigned char* lds, int tid, int vcu, int G) {
    bf16_t* proj = (bf16_t*)(ws + WS_PROJ);
    const size_t SL = (size_t)MT * BW;
    const int lane = tid & 63, wave = __builtin_amdgcn_readfirstlane(tid >> 6);
    if (vcu < 32) {
        if (MK_EN(8)) mlstm_unit(in, layer, vcu >> 2, vcu & 3, proj + SL_MQ * SL, proj + SL_MK * SL, proj + SL_MV * SL, proj + SL_MO * SL, proj + SL_MZ * SL, (const float*)(ws + WS_GIF), lds, tid);
    } else if (vcu < 64) {
        const int u = vcu - 32;
        if (MK_EN(9)) ssm_wave_unit(in, layer, u >> 2, (u & 3) * 8 + wave, proj + SL_SU * SL, lds + wave * 16896, lane);
    }
    __syncthreads();
    const float* dl = in[17] + layer * 256;
    float lam;
    { const float s1 = wave_sum(dl[lane] * dl[64 + lane]), s2 = wave_sum(dl[128 + lane] * dl[192 + lane]);
      const float lam_init = 0.8f - 0.6f * expf(-0.3f * (float)layer); lam = expf(s1) - expf(s2) + lam_init; }
    unsigned* qhead = (unsigned*)(ws + WS_CTL) + CW_QUEUE + 64 * layer;
    LAS unsigned* bc = (LAS unsigned*)(lds + LDS_MAIN - 64);
    for (;;) {
        if (tid == 0) bc[0] = atomicAdd(qhead, 1u);
        __syncthreads();
        const unsigned ui = bc[0];
        __syncthreads();
        if (ui >= 1024u) break;
        const int qb = 31 - (int)(ui >> 5), bh = (int)(ui & 31);
        if (MK_EN(10)) attn_unit(in, layer, bh >> 2, bh & 3, qb, proj + SL_AQ * SL, proj + SL_AK * SL, proj + SL_AV * SL, proj + SL_AZ * SL, lam, lds, tid);
    }
}
struct Args { const float* in[23]; float* out; unsigned char* ws; int ph_lo, ph_hi; };
constexpr int N_PHASES = 12;

__global__ void __launch_bounds__(NTHREADS, 2) mega_fwd(Args a_unused) {
    extern __shared__ __attribute__((aligned(16))) unsigned char lds_raw[];
    LAS unsigned char* lds = (LAS unsigned char*)lds_raw;
    const int tid0 = threadIdx.x;
    const int G = gridDim.x, bx = blockIdx.x;
    const int vcu = (G % 8 == 0) ? (bx % 8) * (G / 8) + bx / 8 : bx;
    for (int u = tid0; u < (LDS_BYTES - LDSCTL_OFF) / 4; u += NTHREADS) ((LAS unsigned*)(lds + LDSCTL_OFF))[u] = 0u;
    __syncthreads();
    typedef const __attribute__((address_space(4))) Args* ArgP;
    ArgP ap0 = (ArgP)__builtin_amdgcn_kernarg_segment_ptr();
    const int ph_lo = ap0->ph_lo, ph_hi = ap0->ph_hi;
    const bool fused = (ph_hi - ph_lo) > 1;
    if (fused) (void)xcd_barrier_post((unsigned*)(ap0->ws + WS_CTL) + CW_BAR, (volatile LAS unsigned*)(lds + LDSCTL_OFF + 32));
    const size_t SL = (size_t)MT * BW;
    for (int ph = ph_lo; ph < ph_hi; ++ph) {
        ArgP ap = (ArgP)__builtin_amdgcn_kernarg_segment_ptr(); asm volatile("" : "+s"(ap));
        InPtr in = ap->in; unsigned char* ws = ap->ws; float* out = ap->out;
        bf16_t* proj = (bf16_t*)(ws + WS_PROJ); float* rs = (float*)(ws + WS_RS);
        int tid = threadIdx.x; asm volatile("" : "+v"(tid));
        if (ph == 0) {
            if (MK_EN(0)) phase_prologue(in, ws, lds, tid, vcu, G);
        } else if (ph == 11) {
            if (MK_EN(6)) phase_final(in, ws, out, tid, vcu, G);
        } else {
            const int layer = (ph - 1) / 5, sub = (ph - 1) % 5;
            bf16_t* xb = (bf16_t*)(ws + WS_XB);
            if (sub == 0) {
                if (MK_EN(7)) gate_if_pass(in, ws, layer, tid, vcu, G);
                pg8::Gemm g{xb, (const bf16_t*)(ws + WS_W1) + (size_t)layer * N1 * DM, MT, N1, DM, 0, 0};
                pg8::StaticOrder S; S.init(MT, N1, G, bx);
                const float lam_init = 0.8f - 0.6f * expf(-0.3f * (float)layer);
                pg8::EpiProj E{proj, rs + (size_t)layer * MT, 1.0f - lam_init};
                if (MK_EN(1)) pg8::gemm_phase<pg8::EpiProj, pg8::StaticOrder, true, true>(lds, g, S, E, tid);
            } else if (sub == 1 && MK_EN(2)) {
                phase_mixers(in, ws, layer, lds, tid, bx, G);
            } else if (sub == 2 && MK_EN(3)) {
                { pg8::Gemm g{proj + SL_SU * SL, (const bf16_t*)(ws + WS_WGLU) + (size_t)layer * BW * BW, MT, BW, BW, 0, 0};
                  pg8::StaticOrder S; S.init(MT, BW, G, bx);
                  pg8::EpiGlu E{proj + SL_SU * SL, proj + SL_SZ * SL, in[16] + layer * BW};
                  pg8::gemm_phase<pg8::EpiGlu, pg8::StaticOrder, true, true>(lds, g, S, E, tid); }
                { pg8::Gemm g{xb, (const bf16_t*)(ws + WS_WG) + (size_t)layer * NG * DM, MT, NG, DM, 0, 0};
                  pg8::StaticOrder S; S.init(MT, NG, G, bx);
                  pg8::EpiGate E{proj + SL_MQ * SL, rs + (size_t)layer * MT};
                  pg8::gemm_phase<pg8::EpiGate, pg8::StaticOrder, true, true>(lds, g, S, E, tid); }
            } else if (sub == 3 && MK_EN(4)) {
                pg8::Gemm g{proj + SL_SZ * SL, (const bf16_t*)(ws + WS_WBR) + (size_t)layer * 3 * DM * BW, MT, DM, BW, SL * 2, (size_t)DM * BW * 2};
                pg8::MergeOrder S; S.S.init(MT, DM, G, bx);
                pg8::EpiMerge E{proj + SL_MQ * SL, proj + SL_SU * SL};
                pg8::gemm_phase<pg8::EpiMerge, pg8::MergeOrder, true, true>(lds, g, S, E, tid);
            } else if (sub == 4 && MK_EN(5)) {
                pg8::Gemm g{proj + SL_SU * SL, (const bf16_t*)(ws + WS_WOUT) + (size_t)layer * DM * DM, MT, DM, DM, 0, 0};
                pg8::StaticOrder S; S.init(MT, DM, G, bx);
                pg8::EpiOut E{layer == 0 ? in[0] : out, out, xb, rs + (size_t)(layer + 1) * MT};
                pg8::gemm_phase<pg8::EpiOut, pg8::StaticOrder, true, true>(lds, g, S, E, tid);
            }
        }
        if (fused && ph + 1 < ph_hi) { XcdBarrier bar; bar.bar = (unsigned*)(ws + WS_CTL) + CW_BAR; bar.x = xb_xcc_id(); bar.st = (volatile LAS unsigned*)(lds + LDSCTL_OFF + 32); xcd_barrier(bar); }
    }
}

extern "C" void kernel_launch(void* const* d_in, const int* in_sizes, int n_in, void* d_out, int out_size, void* d_ws, size_t ws_size, hipStream_t stream) {
    static int grid = 0;
    if (grid == 0) {
        if (n_in != 23 || out_size != MT * DM || ws_size < WS_END) { fprintf(stderr, "kernel_launch: unexpected shapes (n_in %d out %d ws %zu)\n", n_in, out_size, ws_size); grid = -1; return; }
        int dev = 0, cus = 0, per_cu = 0;
        if (hipGetDevice(&dev) != hipSuccess || hipDeviceGetAttribute(&cus, hipDeviceAttributeMultiprocessorCount, dev) != hipSuccess) { grid = -1; return; }
        if (hipFuncSetAttribute((const void*)mega_fwd, hipFuncAttributeMaxDynamicSharedMemorySize, LDS_BYTES) != hipSuccess) { fprintf(stderr, "kernel_launch: hipFuncSetAttribute failed\n"); grid = -1; return; }
        if (hipOccupancyMaxActiveBlocksPerMultiprocessor(&per_cu, (const void*)mega_fwd, NTHREADS, LDS_BYTES) != hipSuccess || per_cu < 1) { fprintf(stderr, "kernel_launch: occupancy query says %d blocks per CU\n", per_cu); (void)hipGetLastError(); grid = -1; return; }
        grid = cus;
    }
    if (grid < 0) return;
    (void)hipMemsetAsync((char*)d_ws + WS_CTL, 0, CTL_BYTES, stream);
    Args a{};
    for (int i = 0; i < 23; ++i) a.in[i] = (const float*)d_in[i];
    a.out = (float*)d_out; a.ws = (unsigned char*)d_ws;
#if MK_FUSED
    a.ph_lo = 0; a.ph_hi = N_PHASES;
    void* args[] = {&a};
    hipError_t e = hipLaunchCooperativeKernel((const void*)mega_fwd, dim3(grid), dim3(NTHREADS), args, LDS_BYTES, stream);
    if (e != hipSuccess) fprintf(stderr, "kernel_launch: cooperative launch failed: %s\n", hipGetErrorString(e));
#else
    for (int ph = 0; ph < N_PHASES; ++ph) {
        a.ph_lo = ph; a.ph_hi = ph + 1;
        hipLaunchKernelGGL(mega_fwd, dim3(grid), dim3(NTHREADS), LDS_BYTES, stream, a);
    }
#endif
}
```
